# Optimizing an MI355X kernel written in HIP

```python
import math
import jax
import jax.numpy as jnp
from jax import lax
import numpy as np

D_MODEL = 2048
BATCH = 4
SEQ = 4096
DEPTH = 1

HEAD_DIM = 64
N_Q_HEADS = 16
N_KV_HEADS = 4
GQA_GROUP = N_Q_HEADS // N_KV_HEADS
ATTN_WIDTH = N_Q_HEADS * HEAD_DIM
KV_WIDTH = N_KV_HEADS * HEAD_DIM
WINDOW = 128
BLOCK = 128
NUM_BUCKETS = 32
MAX_DISTANCE = 128
NEG_INF = -1e30
SSM_WIDTH = D_MODEL // 4
SSM_GROUP_CH = 16
SSM_GROUPS = SSM_WIDTH // SSM_GROUP_CH
SSM_STATE = 64
D_FF = 4 * D_MODEL
N_BRANCHES = 2
IN_WIDTH = ATTN_WIDTH + 2 * KV_WIDTH + SSM_WIDTH + N_BRANCHES * D_MODEL
N_MOD = 6
EPS = 1e-6

kernel_name = "hybrid_swa_sink_s5_gated_adaln_block"


def _rmsnorm(x, g):
    xf = x.astype(jnp.float32)
    y = xf * lax.rsqrt(jnp.mean(xf * xf, axis=-1, keepdims=True) + EPS)
    return (y * g.astype(jnp.float32)).astype(x.dtype)


def _modulate(h, shift, scale):
    return h * (1 + scale[:, None, :]) + shift[:, None, :]


def _t5_buckets_block():
    qi = np.arange(BLOCK)[:, None]
    ki = np.arange(2 * BLOCK)[None, :]
    n = np.maximum(qi + BLOCK - ki, 0)
    max_exact = NUM_BUCKETS // 2
    large = max_exact + (np.log(np.maximum(n, 1) / max_exact)
                         / np.log(MAX_DISTANCE / max_exact)
                         * (NUM_BUCKETS - max_exact)).astype(np.int32)
    large = np.minimum(large, NUM_BUCKETS - 1)
    return np.where(n < max_exact, n, large).astype(np.int32)


def _sliding_window_attention(q, k, v, sinks, bias):
    b, s, _ = q.shape
    nb = s // BLOCK
    q = q.reshape(b, nb, BLOCK, N_KV_HEADS, GQA_GROUP, HEAD_DIM)
    pad = ((0, 0), (BLOCK, 0), (0, 0))
    kp = jnp.pad(k, pad).reshape(b, nb + 1, BLOCK, N_KV_HEADS, HEAD_DIM)
    vp = jnp.pad(v, pad).reshape(b, nb + 1, BLOCK, N_KV_HEADS, HEAD_DIM)
    kk = jnp.concatenate([kp[:, :-1], kp[:, 1:]], axis=2)
    vv = jnp.concatenate([vp[:, :-1], vp[:, 1:]], axis=2)
    scores = jnp.einsum('bnqhgd,bnkhd->bnhgqk', q, kk).astype(jnp.float32)
    scores = scores * (HEAD_DIM ** -0.5) + bias
    qi = jnp.arange(BLOCK)[:, None]
    ki = jnp.arange(2 * BLOCK)[None, :]
    dist = qi + BLOCK - ki
    band = (dist >= 0) & (dist < WINDOW)
    blk = jnp.arange(nb)[:, None, None]
    valid = band[None] & (blk * BLOCK + ki[None] - BLOCK >= 0)
    scores = jnp.where(valid[None, :, None, None], scores, NEG_INF)
    sink = sinks.astype(jnp.float32).reshape(N_KV_HEADS, GQA_GROUP, 1)
    m = jnp.maximum(jnp.max(scores, axis=-1), sink)
    p = jnp.exp(scores - m[..., None])
    denom = jnp.sum(p, axis=-1) + jnp.exp(sink - m)
    p = (p / denom[..., None]).astype(vv.dtype)
    o = jnp.einsum('bnhgqk,bnkhd->bnqhgd', p, vv)
    return o.reshape(b, s, ATTN_WIDTH)


def _ssm_combine(e1, e2):
    (a1r, a1i), (b1r, b1i) = e1
    (a2r, a2i), (b2r, b2i) = e2
    a_new = (a1r * a2r - a1i * a2i, a1r * a2i + a1i * a2r)
    b_new = (a2r * b1r - a2i * b1i + b2r, a2r * b1i + a2i * b1r + b2i)
    return (a_new, b_new)


def _s5_ssm(u, lambda_re, lambda_im, log_step, b_re, b_im, c_re, c_im, d_skip):
    bsz, s, _ = u.shape
    f32 = jnp.float32
    uf = u.astype(f32).reshape(bsz, s, SSM_GROUPS, SSM_GROUP_CH)
    lam_re = jnp.minimum(lambda_re.astype(f32), -1e-4)
    lam_im = lambda_im.astype(f32)
    delta = jnp.exp(log_step.astype(f32))[:, None]
    mag = jnp.exp(lam_re * delta)
    ang = lam_im * delta
    abar_re, abar_im = mag * jnp.cos(ang), mag * jnp.sin(ang)
    num_re, num_im = abar_re - 1.0, abar_im
    den = lam_re * lam_re + lam_im * lam_im
    f_re = (num_re * lam_re + num_im * lam_im) / den
    f_im = (num_im * lam_re - num_re * lam_im) / den
    br, bi = b_re.astype(f32), b_im.astype(f32)
    bbar_re = f_re[..., None] * br - f_im[..., None] * bi
    bbar_im = f_re[..., None] * bi + f_im[..., None] * br
    bu_re = jnp.einsum('bsgp,gnp->bsgn', uf, bbar_re)
    bu_im = jnp.einsum('bsgp,gnp->bsgn', uf, bbar_im)
    shape_a = (1, s, SSM_GROUPS, SSM_STATE)
    a_re = jnp.broadcast_to(abar_re, shape_a)
    a_im = jnp.broadcast_to(abar_im, shape_a)
    _, (x_re, x_im) = lax.associative_scan(
        _ssm_combine, ((a_re, a_im), (bu_re, bu_im)), axis=1)
    y = (jnp.einsum('bsgn,gpn->bsgp', x_re, c_re.astype(f32))
         - jnp.einsum('bsgn,gpn->bsgp', x_im, c_im.astype(f32))
         + d_skip.astype(f32).reshape(SSM_GROUPS, SSM_GROUP_CH) * uf)
    return y.reshape(bsz, s, SSM_WIDTH).astype(u.dtype)


def setup_inputs(seed: int = 0) -> dict:
    key = jax.random.key(seed)
    ks = jax.random.split(key, 32)

    def nrm(k, shape, scale):
        return jax.random.normal(k, shape, jnp.float32) * scale

    G, N, P = SSM_GROUPS, SSM_STATE, SSM_GROUP_CH
    lam_im0 = jnp.pi * jnp.arange(N, dtype=jnp.float32)
    return {
        "x": nrm(ks[0], (BATCH, SEQ, D_MODEL), 1.0),
        "c": nrm(ks[1], (BATCH, D_MODEL), 1.0),
        "w_ada": nrm(ks[2], (DEPTH, D_MODEL, N_MOD * D_MODEL), 0.5 * D_MODEL ** -0.5),
        "b_ada": nrm(ks[3], (DEPTH, N_MOD * D_MODEL), 0.02),
        "norm1_g": 1.0 + nrm(ks[4], (DEPTH, D_MODEL), 0.02),
        "w_in": nrm(ks[5], (DEPTH, D_MODEL, IN_WIDTH), D_MODEL ** -0.5),
        "b_in": nrm(ks[6], (DEPTH, IN_WIDTH), 0.02),
        "attn_sinks": nrm(ks[7], (DEPTH, N_Q_HEADS), 0.5),
        "rel_bias": nrm(ks[8], (NUM_BUCKETS, N_Q_HEADS), 0.1),
        "lambda_re": -0.5 + nrm(ks[9], (DEPTH, G, N), 0.01),
        "lambda_im": lam_im0 + nrm(ks[10], (DEPTH, G, N), 0.01),
        "log_step": jax.random.uniform(ks[11], (DEPTH, G), jnp.float32,
                                       minval=math.log(1e-3), maxval=math.log(1e-1)),
        "ssm_b_re": nrm(ks[12], (DEPTH, G, N, P), (2 * P) ** -0.5),
        "ssm_b_im": nrm(ks[13], (DEPTH, G, N, P), (2 * P) ** -0.5),
        "ssm_c_re": nrm(ks[14], (DEPTH, G, P, N), (2 * N) ** -0.5),
        "ssm_c_im": nrm(ks[15], (DEPTH, G, P, N), (2 * N) ** -0.5),
        "ssm_d": nrm(ks[16], (DEPTH, SSM_WIDTH), 1.0),
        "w_glu": nrm(ks[17], (DEPTH, SSM_WIDTH, SSM_WIDTH), SSM_WIDTH ** -0.5),
        "b_glu": nrm(ks[18], (DEPTH, SSM_WIDTH), 0.02),
        "w_attn_proj": nrm(ks[19], (DEPTH, ATTN_WIDTH, D_MODEL), ATTN_WIDTH ** -0.5),
        "w_ssm_proj": nrm(ks[20], (DEPTH, SSM_WIDTH, D_MODEL), SSM_WIDTH ** -0.5),
        "w_out": nrm(ks[21], (DEPTH, D_MODEL, D_MODEL), D_MODEL ** -0.5),
        "norm2_g": 1.0 + nrm(ks[22], (DEPTH, D_MODEL), 0.02),
        "w_ff1": nrm(ks[23], (DEPTH, D_MODEL, D_FF), D_MODEL ** -0.5),
        "w_ff2": nrm(ks[24], (DEPTH, D_FF, D_MODEL), D_FF ** -0.5),
        "final_g": 1.0 + nrm(ks[25], (D_MODEL,), 0.02),
    }


def reference(x, c, w_ada, b_ada, norm1_g, w_in, b_in, attn_sinks, rel_bias,
              lambda_re, lambda_im, log_step, ssm_b_re, ssm_b_im, ssm_c_re,
              ssm_c_im, ssm_d, w_glu, b_glu, w_attn_proj, w_ssm_proj, w_out,
              norm2_g, w_ff1, w_ff2, final_g):
    bsz, s, _ = x.shape
    buckets = jnp.asarray(_t5_buckets_block())
    bias = rel_bias.astype(jnp.float32)[buckets]
    bias = jnp.transpose(bias, (2, 0, 1)).reshape(N_KV_HEADS, GQA_GROUP, BLOCK, 2 * BLOCK)
    splits = [ATTN_WIDTH, ATTN_WIDTH + KV_WIDTH, ATTN_WIDTH + 2 * KV_WIDTH,
              ATTN_WIDTH + 2 * KV_WIDTH + SSM_WIDTH,
              ATTN_WIDTH + 2 * KV_WIDTH + SSM_WIDTH + D_MODEL]
    cs = jax.nn.silu(c)
    for l in range(DEPTH):
        mod = cs @ w_ada[l] + b_ada[l]
        sh1, sc1, g1, sh2, sc2, g2 = jnp.split(mod, N_MOD, axis=-1)
        h = _modulate(_rmsnorm(x, norm1_g[l]), sh1, sc1)
        proj = h @ w_in[l] + b_in[l]
        q, k, v, u, gate_a, gate_s = jnp.split(proj, splits, axis=-1)
        attn = _sliding_window_attention(q, k, v, attn_sinks[l], bias)
        y_attn = attn @ w_attn_proj[l]
        y = _s5_ssm(u, lambda_re[l], lambda_im[l], log_step[l], ssm_b_re[l],
                    ssm_b_im[l], ssm_c_re[l], ssm_c_im[l], ssm_d[l])
        z = jax.nn.gelu(y)
        z = z * jax.nn.sigmoid(z @ w_glu[l] + b_glu[l])
        y_ssm = z @ w_ssm_proj[l]
        merged = jax.nn.sigmoid(gate_a) * y_attn + jax.nn.sigmoid(gate_s) * y_ssm
        x = x + g1[:, None, :] * (merged @ w_out[l])
        h2 = _modulate(_rmsnorm(x, norm2_g[l]), sh2, sc2)
        ff = jnp.square(jax.nn.relu(h2 @ w_ff1[l])) @ w_ff2[l]
        x = x + g2[:, None, :] * ff
    return _rmsnorm(x, final_g)
```

```cpp
#include <hip/hip_runtime.h>
#include <cstdio>
#include <cstdint>

#ifndef MK_N_LAUNCHES
#define MK_N_LAUNCHES 14
#endif

namespace pg8 {
#define PG8_LAS __attribute__((address_space(3)))
typedef unsigned short bf16_t;
typedef short bf16x8 __attribute__((ext_vector_type(8)));
typedef float f32x4 __attribute__((ext_vector_type(4)));
typedef unsigned u32x4 __attribute__((ext_vector_type(4)));
constexpr int BM = 256, BK = 64, HALF = 128, HTB = HALF * BK * 2  , STAGE_BYTES = 8 * HTB, NXCD = 8, WGM = 8;

__host__ __device__ __forceinline__ int lds_byte(int r, int c) { const int st = (r >> 4) * 2 + (c >> 5), rr = r & 15, cc = c & 31, ob = rr * 64 + cc * 2; return st * 1024 + (ob ^ (((ob >> 9) & 1) << 5)); }
__host__ __device__ __forceinline__ void stage_rc(int b, int& R, int& C) { const int st = b / 1024, sb = b % 1024, swz = sb ^ (((sb >> 9) & 1) << 5); R = (st >> 1) * 16 + swz / 64; C = (st & 1) * 32 + (swz % 64) / 2; }
__host__ __device__ __forceinline__ int perm32(int rho) { const int n = rho >> 4, i = rho & 15; return 8 * (i >> 2) + 4 * n + (i & 3); }

struct Unit { int pm, pn, bt; };
struct Gemm { const bf16_t* A; const bf16_t* Bt; int lda, ldb, K; };

struct StaticOrder {
    int nM, nN, nwg, G, c;
    __host__ __device__ void init(int M, int N, int G_, int c_) { nM = M / BM; nN = N / BM; nwg = nM * nN; G = G_; c = c_; }
    __host__ __device__ bool next(int i, Unit& u) const {
        const long L = (long)i * G + c; if (L >= nwg) return false;
        int wgid = (int)L; { const int q = nwg / NXCD, r = nwg % NXCD, xcd = wgid % NXCD, off = wgid / NXCD; wgid = (xcd < r ? xcd * (q + 1) : r * (q + 1) + (xcd - r) * q) + off; }
        const int nig = WGM * nN, gid = wgid / nig, fm = gid * WGM, gsz = (nM - fm) < WGM ? (nM - fm) : WGM;
        u.pm = fm + ((wgid % nig) % gsz); u.pn = (wgid % nig) / gsz; u.bt = u.pn; return true;
    }
};
struct BatchOrder {
    int nunits, nN, rpg, G, c;
    __host__ __device__ bool next(int i, Unit& u) const {
        const long L = (long)i * G + c; if (c < 0 || L >= nunits) return false;
        u.pm = (int)L / nN; u.pn = (int)L % nN; u.bt = (u.pm / rpg) * nN + u.pn; return true;
    }
};

__device__ __forceinline__ unsigned cvt_pk_bf16(float lo, float hi) { unsigned r; asm volatile("v_cvt_pk_bf16_f32 %0, %1, %2" : "=v"(r) : "v"(lo), "v"(hi)); return r; }
__device__ __forceinline__ float bf_lo(unsigned w) { return __uint_as_float(w << 16); }
__device__ __forceinline__ float bf_hi(unsigned w) { return __uint_as_float(w & 0xffff0000u); }
__device__ __forceinline__ float sigmoidf_(float x) { return __builtin_amdgcn_rcpf(1.0f + __builtin_amdgcn_exp2f(-1.4426950408889634f * x)); }


struct EpiF32 {
    static constexpr bool PERM = false;
    float* C; int ldc;
    __device__ __forceinline__ void operator()(const f32x4 (&acc)[2][2][4][2], const Unit& u, int wr, int wc, int fr, int fq) const {
        const int row0 = u.pm * BM + wr * 64 + fr, col0 = u.pn * BM + wc * 32 + 4 * fq;
#pragma unroll
        for (int ai = 0; ai < 2; ++ai)
#pragma unroll
            for (int m = 0; m < 4; ++m) { float* rowp = C + (size_t)(row0 + ai * HALF + m * 16) * ldc + col0;
#pragma unroll
                for (int bj = 0; bj < 2; ++bj)
#pragma unroll
                    for (int n = 0; n < 2; ++n) *(f32x4*)(rowp + bj * HALF + n * 16) = acc[ai][bj][m][n]; }
    }
};
struct EpiResid {
    static constexpr bool PERM = false;
    const float* base; float* out; const float* gate; int gstride;
    __device__ __forceinline__ void operator()(const f32x4 (&acc)[2][2][4][2], const Unit& u, int wr, int wc, int fr, int fq) const {
        const int row0 = u.pm * BM + wr * 64 + fr, col0 = u.pn * BM + wc * 32 + 4 * fq;
        const float* gp = gate + (size_t)(u.pm >> 4) * gstride + col0;
        f32x4 gv[2][2];
#pragma unroll
        for (int bj = 0; bj < 2; ++bj)
#pragma unroll
            for (int n = 0; n < 2; ++n) gv[bj][n] = *(const f32x4*)(gp + bj * HALF + n * 16);
#pragma unroll
        for (int ai = 0; ai < 2; ++ai)
#pragma unroll
            for (int m = 0; m < 4; ++m) { const size_t off = (size_t)(row0 + ai * HALF + m * 16) * 2048 + col0;
#pragma unroll
                for (int bj = 0; bj < 2; ++bj)
#pragma unroll
                    for (int n = 0; n < 2; ++n) { const f32x4 bs = *(const f32x4*)(base + off + bj * HALF + n * 16);
                        *(f32x4*)(out + off + bj * HALF + n * 16) = bs + gv[bj][n] * acc[ai][bj][m][n]; }
                if (m & 1) asm volatile("" ::: "memory"); }
    }
};
template <int MODE> struct EpiBf {
    static constexpr bool PERM = true;
    bf16_t* O; int ldo; const bf16_t* X; const float* bias;
    __device__ __forceinline__ void operator()(const f32x4 (&acc)[2][2][4][2], const Unit& u, int wr, int wc, int fr, int fq) const {
        const int row0 = u.pm * BM + wr * 64 + fr, col0 = u.pn * BM + wc * 32 + 8 * fq;
        f32x4 bv[2][2];
#pragma unroll
        for (int bj = 0; bj < 2; ++bj)
#pragma unroll
            for (int n = 0; n < 2; ++n) bv[bj][n] = (MODE == 1) ? *(const f32x4*)(bias + col0 + bj * HALF + 4 * n) : (f32x4){0.f, 0.f, 0.f, 0.f};
#pragma unroll
        for (int ai = 0; ai < 2; ++ai)
#pragma unroll
            for (int m = 0; m < 4; ++m) { const size_t off = (size_t)(row0 + ai * HALF + m * 16) * ldo + col0;
#pragma unroll
                for (int bj = 0; bj < 2; ++bj) { f32x4 v0 = acc[ai][bj][m][0], v1 = acc[ai][bj][m][1];
                    if (MODE == 0) {
#pragma unroll
                        for (int j = 0; j < 4; ++j) { const float a = fmaxf(v0[j], 0.f), b = fmaxf(v1[j], 0.f); v0[j] = a * a; v1[j] = b * b; } }
                    if (MODE == 1 || MODE == 2 || MODE == 3) {
                        const u32x4 xw = *(const u32x4*)(X + off + bj * HALF);
                        const f32x4 x0 = {bf_lo(xw.x), bf_hi(xw.x), bf_lo(xw.y), bf_hi(xw.y)}, x1 = {bf_lo(xw.z), bf_hi(xw.z), bf_lo(xw.w), bf_hi(xw.w)};
                        if (MODE == 1) {
#pragma unroll
                            for (int j = 0; j < 4; ++j) { v0[j] = x0[j] * sigmoidf_(v0[j] + bv[bj][0][j]); v1[j] = x1[j] * sigmoidf_(v1[j] + bv[bj][1][j]); } }
                        if (MODE == 2) { v0 = v0 * x0; v1 = v1 * x1; }
                        if (MODE == 3) { const u32x4 ow = *(const u32x4*)(O + off + bj * HALF);
                            const f32x4 o0 = {bf_lo(ow.x), bf_hi(ow.x), bf_lo(ow.y), bf_hi(ow.y)}, o1 = {bf_lo(ow.z), bf_hi(ow.z), bf_lo(ow.w), bf_hi(ow.w)};
                            v0 = o0 + v0 * x0; v1 = o1 + v1 * x1; } }
                    u32x4 w; w.x = cvt_pk_bf16(v0[0], v0[1]); w.y = cvt_pk_bf16(v0[2], v0[3]); w.z = cvt_pk_bf16(v1[0], v1[1]); w.w = cvt_pk_bf16(v1[2], v1[3]);
                    *(u32x4*)(O + off + bj * HALF) = w; } }
    }
};
struct EpiInProj {
    static constexpr bool PERM = true;
    const float* bias; bf16_t *Q, *Kb, *Vb, *U, *GA, *GS; float qscale;
    __device__ __forceinline__ void operator()(const f32x4 (&acc)[2][2][4][2], const Unit& u, int wr, int wc, int fr, int fq) const {
        const int pn = u.pn, row0 = u.pm * BM + wr * 64 + fr, cl0 = wc * 32 + 8 * fq, bcol0 = pn * BM + cl0;
        f32x4 bv[2][2];
#pragma unroll
        for (int bj = 0; bj < 2; ++bj)
#pragma unroll
            for (int n = 0; n < 2; ++n) bv[bj][n] = *(const f32x4*)(bias + bcol0 + bj * HALF + 4 * n);
        bf16_t* base; int ld, coff; float sc = 1.f; int mode = 0;
        if (pn < 4) { base = Q; ld = 1024; coff = pn * 256; sc = qscale; }
        else if (pn == 4) { base = Kb; ld = 256; coff = 0; }
        else if (pn == 5) { base = Vb; ld = 256; coff = 0; }
        else if (pn < 8) { base = U; ld = 0; coff = (pn - 6) * 256; mode = 2; }
        else if (pn < 16) { base = GA; ld = 2048; coff = (pn - 8) * 256; mode = 1; }
        else { base = GS; ld = 2048; coff = (pn - 16) * 256; mode = 1; }
#pragma unroll
        for (int ai = 0; ai < 2; ++ai)
#pragma unroll
            for (int m = 0; m < 4; ++m) { const int r = row0 + ai * HALF + m * 16;
#pragma unroll
                for (int bj = 0; bj < 2; ++bj) { f32x4 v0 = acc[ai][bj][m][0] + bv[bj][0], v1 = acc[ai][bj][m][1] + bv[bj][1];
                    const int c = coff + cl0 + bj * HALF;
                    bf16_t* dst;
                    if (mode == 1) {
#pragma unroll
                        for (int j = 0; j < 4; ++j) { v0[j] = sigmoidf_(v0[j]); v1[j] = sigmoidf_(v1[j]); } }
                    else { v0 = v0 * sc; v1 = v1 * sc; }
                    if (mode == 2) { const int g = c >> 4, q0 = c & 15, ch = r >> 5, sl = r & 31; dst = base + ((size_t)(g * 512 + ch) * 640 + sl * 16 + q0); }
                    else dst = base + (size_t)r * ld + c;
                    u32x4 w; w.x = cvt_pk_bf16(v0[0], v0[1]); w.y = cvt_pk_bf16(v0[2], v0[3]); w.z = cvt_pk_bf16(v1[0], v1[1]); w.w = cvt_pk_bf16(v1[2], v1[3]);
                    *(u32x4*)dst = w; } }
    }
};
struct EpiSsmOut {
    static constexpr bool PERM = true;
    bf16_t* Z;
    __device__ __forceinline__ void operator()(const f32x4 (&acc)[2][2][4][2], const Unit& u, int wr, int wc, int fr, int fq) const {
        const int g = u.pm >> 1, ch0 = (u.pm & 1) * 256 + wr * 64 + fr, cl0 = u.pn * BM + wc * 32 + 8 * fq;
#pragma unroll
        for (int ai = 0; ai < 2; ++ai)
#pragma unroll
            for (int m = 0; m < 4; ++m) { const int ch = ch0 + ai * HALF + m * 16;
#pragma unroll
                for (int bj = 0; bj < 2; ++bj) { f32x4 v0 = acc[ai][bj][m][0], v1 = acc[ai][bj][m][1];
                    const int c = cl0 + bj * HALF, t = c >> 4, p0 = c & 15;
#pragma unroll
                    for (int j = 0; j < 4; ++j) { const float a = v0[j], b = v1[j];
                        v0[j] = a * sigmoidf_(1.5957691216057308f * (a + 0.044715f * a * a * a));
                        v1[j] = b * sigmoidf_(1.5957691216057308f * (b + 0.044715f * b * b * b)); }
                    u32x4 w; w.x = cvt_pk_bf16(v0[0], v0[1]); w.y = cvt_pk_bf16(v0[2], v0[3]); w.z = cvt_pk_bf16(v1[0], v1[1]); w.w = cvt_pk_bf16(v1[2], v1[3]);
                    *(u32x4*)(Z + (size_t)(ch * 32 + t) * 512 + g * 16 + p0) = w; } }
    }
};

template <class Epi, class Sched, bool ALIGN_EPI = false, bool SP2 = false>
__device__ __forceinline__ void gemm_phase(PG8_LAS unsigned char* lds, const Gemm g, const Sched& S, const Epi& E) {
    const int tid = threadIdx.x, wid = __builtin_amdgcn_readfirstlane(tid >> 6), lane = tid & 63, wr = wid >> 2, wc = wid & 3, fr = lane & 15, fq = lane >> 4;
    const int K = g.K, nt = K / BK;
    unsigned voffA[2], voffB[2];
#pragma unroll
    for (int i = 0; i < 2; ++i) { int R, C; stage_rc(tid * 16 + i * 8192, R, C); const int Rb = Epi::PERM ? ((R & ~31) + perm32(R & 31)) : R;
        voffA[i] = (unsigned)(R * g.lda + C) * 2u; voffB[i] = (unsigned)(Rb * g.ldb + C) * 2u; }
    const size_t kstep = (size_t)(BK * 2);
    const size_t hstepA = (size_t)HALF * g.lda * 2, hstepB = (size_t)HALF * g.ldb * 2;
    const size_t tstepA = 2 * hstepA, tstepB = 2 * hstepB;
    const unsigned ldsw = (unsigned)wid * 1024u;
    const int aoff = lds_byte(wr * 64 + fr, fq * 8), boff = lds_byte(wc * 32 + fr, fq * 8);
#define PG8_SA(b, h) (((b) * 2 + (h)) * HTB)
#define PG8_SB(b, h) ((4 + (b) * 2 + (h)) * HTB)
#define PG8_STAGE(bufoff, gbase, voff) do { _Pragma("unroll") for (int _i = 0; _i < 2; ++_i) \
        __builtin_amdgcn_global_load_lds((const unsigned*)((const char*)(gbase) + (voff)[_i]), (PG8_LAS unsigned*)(lds + (bufoff) + ldsw + _i * 8192), 16, 0, 0); } while (0)
#define PG8_LDA(dst, b, h) do { _Pragma("unroll") for (int m = 0; m < 4; ++m) _Pragma("unroll") for (int k = 0; k < 2; ++k) dst[m][k] = *(const PG8_LAS bf16x8*)(lds + PG8_SA(b, h) + aoff + m * 2048 + k * 1024); } while (0)
#define PG8_LDB(dst, b, h) do { _Pragma("unroll") for (int n = 0; n < 2; ++n) _Pragma("unroll") for (int k = 0; k < 2; ++k) dst[n][k] = *(const PG8_LAS bf16x8*)(lds + PG8_SB(b, h) + boff + n * 2048 + k * 1024); } while (0)
#define PG8_MMA(ai, bj, At, Bt) do { __builtin_amdgcn_s_setprio(1); _Pragma("unroll") for (int m = 0; m < 4; ++m) _Pragma("unroll") for (int n = 0; n < 2; ++n) _Pragma("unroll") for (int k = 0; k < 2; ++k) \
        acc[ai][bj][m][n] = __builtin_amdgcn_mfma_f32_16x16x32_bf16(Bt[n][k], At[m][k], acc[ai][bj][m][n], 0, 0, 0); __builtin_amdgcn_s_setprio(0); } while (0)
#define PG8_WAIT_V(n) asm volatile("s_waitcnt vmcnt(" #n ")" ::: "memory")
#define PG8_WAIT_L(n) asm volatile("s_waitcnt lgkmcnt(" #n ")" ::: "memory")
#define PG8_BAR __builtin_amdgcn_s_barrier()
#define PG8_SCHED __builtin_amdgcn_sched_barrier(0)
    Unit cur, nxt; int ui = 0;
    if (!S.next(0, cur)) return;
    f32x4 acc[2][2][4][2];
#pragma unroll
    for (int a = 0; a < 2; ++a)
#pragma unroll
        for (int b = 0; b < 2; ++b)
#pragma unroll
            for (int m = 0; m < 4; ++m)
#pragma unroll
                for (int n = 0; n < 2; ++n) acc[a][b][m][n] = (f32x4){0.f, 0.f, 0.f, 0.f};
    bf16x8 At[4][2], B0[2][2], B1[2][2];
    const char* cA = (const char*)g.A + (size_t)cur.pm * tstepA; const char* cB = (const char*)g.Bt + (size_t)cur.bt * tstepB;
    if constexpr (SP2) {
        PG8_STAGE(PG8_SB(0, 0), cB, voffB); PG8_STAGE(PG8_SB(0, 1), cB + hstepB, voffB); PG8_STAGE(PG8_SA(0, 0), cA, voffA); PG8_STAGE(PG8_SA(0, 1), cA + hstepA, voffA);
        if (wr == 1) PG8_BAR;
        PG8_WAIT_V(2); PG8_BAR;
        PG8_STAGE(PG8_SB(1, 0), cB + kstep, voffB); PG8_STAGE(PG8_SA(1, 0), cA + kstep, voffA); PG8_STAGE(PG8_SB(1, 1), cB + hstepB + kstep, voffB);
        PG8_WAIT_V(6); PG8_BAR;
    } else {
        PG8_STAGE(PG8_SB(0, 0), cB, voffB); PG8_STAGE(PG8_SA(0, 0), cA, voffA); PG8_STAGE(PG8_SB(0, 1), cB + hstepB, voffB); PG8_STAGE(PG8_SA(0, 1), cA + hstepA, voffA);
        if (wr == 1) PG8_BAR;
        PG8_WAIT_V(4); PG8_BAR;
        PG8_STAGE(PG8_SB(1, 0), cB + kstep, voffB); PG8_STAGE(PG8_SA(1, 0), cA + kstep, voffA); PG8_STAGE(PG8_SB(1, 1), cB + hstepB + kstep, voffB);
        PG8_WAIT_V(6); PG8_BAR;
    }
    for (;;) {
        const bool has_next = S.next(ui + 1, nxt);
        const char* nA = has_next ? (const char*)g.A + (size_t)nxt.pm * tstepA : cA; const char* nB = has_next ? (const char*)g.Bt + (size_t)nxt.bt * tstepB : cB;
        for (int t = 0; t < nt; t += 2) {
            const bool last = (t == nt - 2);
            const char* a1 = cA + (size_t)(t + 1) * kstep;
            const char* a2 = last ? nA : cA + (size_t)(t + 2) * kstep; const char* b2 = last ? nB : cB + (size_t)(t + 2) * kstep;
            const char* a3 = a2 + kstep; const char* b3 = b2 + kstep;
            if constexpr (SP2) {
            PG8_LDB(B0, 0, 0); PG8_LDB(B1, 0, 1); PG8_SCHED; PG8_LDA(At, 0, 0); PG8_STAGE(PG8_SA(1, 1), a1 + hstepA, voffA);
            PG8_WAIT_V(8); PG8_WAIT_L(0); PG8_BAR; PG8_MMA(0, 0, At, B0); PG8_MMA(0, 1, At, B1); PG8_BAR; PG8_SCHED;
            PG8_LDA(At, 0, 1); PG8_STAGE(PG8_SB(0, 0), b2, voffB); PG8_STAGE(PG8_SB(0, 1), b2 + hstepB, voffB); PG8_STAGE(PG8_SA(0, 0), a2, voffA);
            PG8_WAIT_V(8); PG8_WAIT_L(0); PG8_BAR; PG8_MMA(1, 0, At, B0); PG8_MMA(1, 1, At, B1); PG8_BAR; PG8_SCHED;
            PG8_LDB(B0, 1, 0); PG8_LDB(B1, 1, 1); PG8_SCHED; PG8_LDA(At, 1, 0); PG8_STAGE(PG8_SA(0, 1), a2 + hstepA, voffA);
            PG8_WAIT_V(8); PG8_WAIT_L(0); PG8_BAR; PG8_MMA(0, 0, At, B0); PG8_MMA(0, 1, At, B1); PG8_BAR; PG8_SCHED;
            PG8_LDA(At, 1, 1); PG8_STAGE(PG8_SB(1, 0), b3, voffB); PG8_STAGE(PG8_SB(1, 1), b3 + hstepB, voffB); PG8_STAGE(PG8_SA(1, 0), a3, voffA);
            PG8_WAIT_V(8); PG8_WAIT_L(0); PG8_BAR; PG8_MMA(1, 0, At, B0); PG8_MMA(1, 1, At, B1); PG8_BAR; PG8_SCHED;
            } else {
            PG8_LDB(B0, 0, 0); PG8_SCHED; PG8_LDA(At, 0, 0); PG8_STAGE(PG8_SA(1, 1), a1 + hstepA, voffA);
            PG8_WAIT_L(8); PG8_BAR; PG8_WAIT_L(0); PG8_MMA(0, 0, At, B0); PG8_BAR; PG8_SCHED;
            PG8_LDB(B1, 0, 1); PG8_STAGE(PG8_SB(0, 0), b2, voffB);
            PG8_BAR; PG8_WAIT_L(0); PG8_MMA(0, 1, At, B1); PG8_BAR;
            PG8_LDA(At, 0, 1); PG8_STAGE(PG8_SA(0, 0), a2, voffA);
            PG8_BAR; PG8_WAIT_L(0); PG8_MMA(1, 0, At, B0); PG8_BAR; PG8_SCHED;
            PG8_STAGE(PG8_SB(0, 1), b2 + hstepB, voffB);
            PG8_WAIT_V(6); PG8_BAR; PG8_MMA(1, 1, At, B1); PG8_BAR;
            PG8_LDB(B0, 1, 0); PG8_SCHED; PG8_LDA(At, 1, 0); PG8_STAGE(PG8_SA(0, 1), a2 + hstepA, voffA);
            PG8_WAIT_L(8); PG8_BAR; PG8_WAIT_L(0); PG8_MMA(0, 0, At, B0); PG8_BAR; PG8_SCHED;
            PG8_LDB(B1, 1, 1); PG8_STAGE(PG8_SB(1, 0), b3, voffB);
            PG8_BAR; PG8_WAIT_L(0); PG8_MMA(0, 1, At, B1); PG8_BAR;
            PG8_LDA(At, 1, 1); PG8_STAGE(PG8_SA(1, 0), a3, voffA);
            PG8_BAR; PG8_WAIT_L(0); PG8_MMA(1, 0, At, B0); PG8_BAR; PG8_SCHED;
            PG8_STAGE(PG8_SB(1, 1), b3 + hstepB, voffB);
            PG8_WAIT_V(6); PG8_BAR; PG8_MMA(1, 1, At, B1); PG8_BAR;
            }
        }
        if constexpr (ALIGN_EPI) { if (wr == 0) PG8_BAR; }
        E(acc, cur, wr, wc, fr, fq);
        if (!has_next) break;
#pragma unroll
        for (int a = 0; a < 2; ++a)
#pragma unroll
            for (int b = 0; b < 2; ++b)
#pragma unroll
                for (int m = 0; m < 4; ++m)
#pragma unroll
                    for (int n = 0; n < 2; ++n) acc[a][b][m][n] = (f32x4){0.f, 0.f, 0.f, 0.f};
        cur = nxt; cA = nA; cB = nB; ++ui;
        if constexpr (ALIGN_EPI) { if (wr == 1) PG8_BAR; }
    }
    PG8_WAIT_V(0);
    if constexpr (!ALIGN_EPI) { if (wr == 0) PG8_BAR; }
    PG8_BAR;
#undef PG8_SA
#undef PG8_SB
#undef PG8_STAGE
#undef PG8_LDA
#undef PG8_LDB
#undef PG8_MMA
#undef PG8_WAIT_V
#undef PG8_WAIT_L
#undef PG8_BAR
#undef PG8_SCHED
}
}

#ifndef PG8_SP2
#define PG8_SP2 true
#endif
#ifndef PG8_ALIGN
#define PG8_ALIGN true
#endif

constexpr int NWAVES = 8;
constexpr int BATCH = 4, SEQ = 4096, DM = 2048, TOK = BATCH * SEQ;
constexpr int AW = 1024, KVW = 256, SW = 512, DFF = 8192, INW = 6144, NMOD = 6;
constexpr int SSM_G = 32, SSM_N = 64, SSM_P = 16, SSM_L = 32, SSM_NCH = TOK / SSM_L  , SSM_K2 = SSM_L * SSM_P + 2 * SSM_N  ;
constexpr float EPS = 1e-6f;
constexpr float LOG2E = 1.4426950408889634f;
constexpr int N_PHASES = 14;
constexpr int N_LAUNCHES = MK_N_LAUNCHES;
static_assert(N_LAUNCHES == 1 || N_LAUNCHES == N_PHASES, "MK_N_LAUNCHES is 1 or 14");

constexpr size_t MiB = 1u << 20;
constexpr size_t WS_CTL = 0, CTL_ZERO_BYTES = 64 * 1024;
constexpr size_t WS_MOD = 1 * MiB;
constexpr size_t WS_A32 = 1 * MiB + 512 * 1024;
constexpr size_t WS_W1 = 2 * MiB, WS_W2 = 34 * MiB, WS_H2 = 66 * MiB;
constexpr size_t WS_H = 130 * MiB;
constexpr size_t WS_Q = 194 * MiB;
constexpr size_t WS_K = 226 * MiB, WS_V = 234 * MiB;
constexpr size_t WS_U = 242 * MiB;
constexpr size_t WS_S = 262 * MiB;
constexpr size_t WS_GA = 278 * MiB, WS_GS = 342 * MiB;
constexpr size_t WS_HID = 130 * MiB;
constexpr size_t WS_WIN = 406 * MiB, WS_WGLU = 430 * MiB, WS_WA = 431 * MiB, WS_WS = 435 * MiB, WS_WO = 437 * MiB, WS_BT1 = 445 * MiB, WS_BT2 = 453 * MiB, WS_END = 473 * MiB;
constexpr int CW_BAR = 4096;

constexpr int RING_OFF = 0, RING_BYTES = 131072;
constexpr int LDSCTL_OFF = RING_BYTES, MISC_OFF = LDSCTL_OFF + 320;
constexpr int LDS_BYTES = 147456;

#define GAS __attribute__((address_space(1)))
#define LAS __attribute__((address_space(3)))
typedef unsigned short bf16;
typedef unsigned v4u __attribute__((ext_vector_type(4)));
typedef unsigned v2u __attribute__((ext_vector_type(2)));
typedef float f32x4 __attribute__((ext_vector_type(4)));
typedef float f32x2 __attribute__((ext_vector_type(2)));
typedef float f32x16 __attribute__((ext_vector_type(16)));
typedef short bf16x8 __attribute__((ext_vector_type(8)));
typedef short s16x4 __attribute__((ext_vector_type(4)));
typedef GAS unsigned gu32;
#define RLX_AGENT __ATOMIC_RELAXED, __HIP_MEMORY_SCOPE_AGENT
#define LDS_WAIT() asm volatile("s_waitcnt lgkmcnt(0)" ::: "memory")
#define VM_WAIT() asm volatile("s_waitcnt vmcnt(0)" ::: "memory")
__device__ __forceinline__ unsigned f2bf(float f) { unsigned u = __builtin_bit_cast(unsigned, f); return (u + 0x7fffu + ((u >> 16) & 1u)) >> 16; }
__device__ __forceinline__ unsigned pk2(float lo, float hi) { return f2bf(lo) | (f2bf(hi) << 16); }

#define XB_TMO      128
#define XB_XCNT(j)  (256  + 64 * (j))
#define XB_XSUB(j)  (1280 + 64 * (j))
#define XB_XGEN(j)  (2304 + 64 * (j))
#define XB_TOP      3328
#define XB_TOPGEN   3392
#define XCD_BAR_WORDS 3456
#define XB_SPIN_CAP (1u << 18)
__device__ __forceinline__ unsigned xb_ld(unsigned* p)              { return __hip_atomic_load(p, __ATOMIC_RELAXED, __HIP_MEMORY_SCOPE_AGENT); }
__device__ __forceinline__ unsigned xb_add(unsigned* p, unsigned v) { return __hip_atomic_fetch_add(p, v, __ATOMIC_RELAXED, __HIP_MEMORY_SCOPE_AGENT); }
__device__ __forceinline__ unsigned xb_xcc_id() { return (unsigned)__builtin_amdgcn_s_getreg((3 << 11) | 20) & 0xFu; }
#define XB_SPIN(cond, bar) do { unsigned _sp = 0; while (cond) { __builtin_amdgcn_s_sleep(1); \
    if ((++_sp & 255u) == 0u) { if (xb_ld(&(bar)[XB_TMO])) break; if (_sp > XB_SPIN_CAP) { atomicAdd(&(bar)[XB_TMO], 1u); break; } } } } while (0)
struct XcdBarrier { unsigned* bar; unsigned x; volatile LAS unsigned* st; };
__device__ __forceinline__ XcdBarrier xcd_barrier_post(unsigned* bar, volatile LAS unsigned* st) {
    XcdBarrier b; b.bar = bar; b.x = xb_xcc_id(); b.st = st;
    if (threadIdx.x == 0) (void)xb_add(&bar[XB_XCNT(b.x)], 1u);
    return b;
}
__device__ __forceinline__ void xcd_barrier_complete(unsigned* bar, unsigned x, unsigned& nloc, unsigned& nx) {
    const unsigned G = gridDim.x * gridDim.y * gridDim.z;
    unsigned sum, cnt, mine, sp = 0u;
    for (;;) {
        sum = 0u; cnt = 0u; mine = 0u;
#pragma unroll
        for (unsigned j = 0; j < 16; ++j) { const unsigned c = xb_ld(&bar[XB_XCNT(j)]); sum += c; cnt += (c > 0u) ? 1u : 0u; mine = (j == x) ? c : mine; }
        if (sum == G) break;
        __builtin_amdgcn_s_sleep(1);
        if ((++sp & 255u) == 0u) { if (xb_ld(&bar[XB_TMO])) break; if (sp > XB_SPIN_CAP) { atomicAdd(&bar[XB_TMO], 1u); break; } }
    }
    nloc = mine > 0u ? mine : 1u; nx = cnt > 0u ? cnt : 1u;
}
__device__ __forceinline__ void xcd_barrier(const XcdBarrier& b) {
    asm volatile("s_waitcnt vmcnt(0)" ::: "memory");
    __syncthreads();
    if (threadIdx.x == 0) {
        unsigned* bar = b.bar;
        __builtin_amdgcn_s_waitcnt(0);
        unsigned nloc = b.st[0], nx = b.st[1];
        if (nloc == 0u) { xcd_barrier_complete(bar, b.x, nloc, nx); b.st[0] = nloc; b.st[1] = nx; }
        const unsigned old = xb_add(&bar[XB_XSUB(b.x)], 1u);
        const unsigned gen = old / nloc;
        if (old + 1u == (gen + 1u) * nloc) {
            __builtin_amdgcn_fence(__ATOMIC_RELEASE, "agent");
            asm volatile("s_waitcnt vmcnt(0)" ::: "memory");
            const unsigned og = xb_add(&bar[XB_TOP], 1u);
            const unsigned tg = og / nx;
            if (og + 1u == (tg + 1u) * nx) xb_add(&bar[XB_TOPGEN], 1u);
            else XB_SPIN(xb_ld(&bar[XB_TOPGEN]) == tg, bar);
            __builtin_amdgcn_fence(__ATOMIC_ACQUIRE, "agent");
            xb_add(&bar[XB_XGEN(b.x)], 1u);
            asm volatile("s_waitcnt vmcnt(0)" ::: "memory");
        } else {
            XB_SPIN(xb_ld(&bar[XB_XGEN(b.x)]) == gen, bar);
            __builtin_amdgcn_fence(__ATOMIC_ACQUIRE, "agent");
            asm volatile("s_waitcnt vmcnt(0)" ::: "memory");
        }
    }
    __syncthreads();
}

struct Frame {
    LAS unsigned char* lds;
    volatile LAS unsigned* MISC;
    gu32* ctl;
    int tid, lane, wave;
    int vcu, G;
};
__device__ __forceinline__ float wave_sum(float v) {
#pragma unroll
    for (int o = 1; o < 64; o <<= 1) v += __shfl_xor(v, o);
    return v;
}
__device__ __forceinline__ float siluf_(float x) { return x / (1.0f + __expf(-x)); }

__device__ __forceinline__ void p0_mod(Frame& F, const float* c, const float* w_ada, const float* b_ada, float* mod, int wg) {
    LAS f32x4* sl = (LAS f32x4*)(F.lds + RING_OFF);
    LAS float* red = (LAS float*)(F.lds + RING_OFF + 32768);
    for (int k = F.tid; k < DM; k += NWAVES * 64) { f32x4 s; s.x = siluf_(c[k]); s.y = siluf_(c[DM + k]); s.z = siluf_(c[2 * DM + k]); s.w = siluf_(c[3 * DM + k]); sl[k] = s; }
    __syncthreads();
    f32x4 acc[4];
#pragma unroll
    for (int b = 0; b < 4; ++b) acc[b] = (f32x4){0.f, 0.f, 0.f, 0.f};
    const int cg = F.lane & 15, rs = F.lane >> 4;
    const float* wp = w_ada + (size_t)(256 * F.wave + rs) * (NMOD * DM) + 64 * wg + 4 * cg;
#pragma unroll 8
    for (int it = 0; it < 64; ++it) {
        const f32x4 w4 = *(const f32x4*)(wp + (size_t)(4 * it) * (NMOD * DM));
        const f32x4 s4 = sl[256 * F.wave + 4 * it + rs];
        acc[0] += s4.x * w4; acc[1] += s4.y * w4; acc[2] += s4.z * w4; acc[3] += s4.w * w4;
    }
#pragma unroll
    for (int b = 0; b < 4; ++b)
#pragma unroll
        for (int j = 0; j < 4; ++j) { float v = acc[b][j]; v += __shfl_xor(v, 16); v += __shfl_xor(v, 32); acc[b][j] = v; }
    if (F.lane < 16) {
#pragma unroll
        for (int b = 0; b < 4; ++b)
#pragma unroll
            for (int j = 0; j < 4; ++j) red[(F.wave * 4 + b) * 64 + 4 * cg + j] = acc[b][j];
    }
    __syncthreads();
    if (F.tid < 256) { const int b = F.tid >> 6, col = F.tid & 63; float s = 0.f;
#pragma unroll
        for (int w = 0; w < 8; ++w) s += red[(w * 4 + b) * 64 + col];
        mod[(size_t)b * (NMOD * DM) + 64 * wg + col] = s + b_ada[64 * wg + col]; }
    __syncthreads();
}
__device__ __forceinline__ void p0_transpose_item(const float* W, int K, int N, bf16* WT, LAS float* scr, int item, int lane) {
    const int nblk = N / 32, kb = item / nblk, nb = item % nblk, k0 = 64 * kb, n0 = 32 * nb;
#pragma unroll 8
    for (int i = 0; i < 32; ++i) { const int kk = 2 * i + (lane >> 5); scr[kk * 33 + (lane & 31)] = W[(size_t)(k0 + kk) * N + n0 + (lane & 31)]; }
    LDS_WAIT(); asm volatile("" ::: "memory");
    const int c = lane & 7;
#pragma unroll
    for (int j = 0; j < 4; ++j) { const int n = (lane >> 3) + 8 * j; const LAS float* s = scr + (8 * c) * 33 + n;
        v4u o; o.x = pk2(s[0 * 33], s[1 * 33]); o.y = pk2(s[2 * 33], s[3 * 33]); o.z = pk2(s[4 * 33], s[5 * 33]); o.w = pk2(s[6 * 33], s[7 * 33]);
        *(GAS v4u*)(WT + (size_t)(n0 + n) * K + k0 + 8 * c) = o; }
    LDS_WAIT(); asm volatile("" ::: "memory");
}
struct SsmIn { const float *lre, *lim, *lstep, *bre, *bim, *cre, *cim, *dsk; };
__device__ __forceinline__ void p0_ssm_ops(Frame& F, const SsmIn& I, bf16* Bt1, bf16* Bt2, float* A32, int g, int part) {
    LAS f32x2* ap = (LAS f32x2*)(F.lds + RING_OFF);
    LAS f32x2* bb = (LAS f32x2*)(F.lds + RING_OFF + 17408);
    LAS f32x2* ct = (LAS f32x2*)(F.lds + RING_OFF + 25600);
    LAS float* kt = (LAS float*)(F.lds + RING_OFF + 33792);
    LAS f32x2* ff = (LAS f32x2*)(F.lds + RING_OFF + 66560);
    const int tid = F.tid;
    const float delta = __expf(I.lstep[g]);
    for (int i = tid; i < 33 * 64; i += 512) { const int j = i >> 6, n = i & 63;
        const float lr = fminf(I.lre[g * 64 + n], -1e-4f), li = I.lim[g * 64 + n];
        const float mag = expf((float)j * (lr * delta)); float sn, cs; sincosf((float)j * (li * delta), &sn, &cs);
        ap[i] = (f32x2){mag * cs, mag * sn}; }
    if (tid < 64) { const int n = tid; const float lr = fminf(I.lre[g * 64 + n], -1e-4f), li = I.lim[g * 64 + n];
        const float mag = expf(lr * delta); float sn, cs; sincosf(li * delta, &sn, &cs);
        const float nr = mag * cs - 1.0f, ni = mag * sn, den = lr * lr + li * li;
        ff[n] = (f32x2){(nr * lr + ni * li) / den, (ni * lr - nr * li) / den}; }
    __syncthreads();
    for (int i = tid; i < 1024; i += 512) { const int n = i >> 4, q = i & 15; const f32x2 f = ff[n];
        const float br = I.bre[(g * 64 + n) * 16 + q], bi = I.bim[(g * 64 + n) * 16 + q];
        bb[i] = (f32x2){f.x * br - f.y * bi, f.x * bi + f.y * br};
        const int p = i & 15, n2 = i >> 4;
        ct[n2 * 16 + p] = (f32x2){I.cre[(g * 16 + p) * 64 + n2], I.cim[(g * 16 + p) * 64 + n2]}; }
    __syncthreads();
    if (part == 0 && tid < 64) { const f32x2 a = ap[32 * 64 + tid]; A32[(g * 64 + tid) * 2] = a.x; A32[(g * 64 + tid) * 2 + 1] = a.y; }
    {
        const int j = tid >> 4, p = tid & 15; float ka[16];
#pragma unroll
        for (int q = 0; q < 16; ++q) ka[q] = 0.f;
        for (int n = 0; n < 64; ++n) { const f32x2 c = ct[n * 16 + p], a = ap[j * 64 + n];
            const float cr = c.x * a.x - c.y * a.y, ci = c.x * a.y + c.y * a.x;
#pragma unroll
            for (int q = 0; q < 16; ++q) { const f32x2 b = bb[n * 16 + q]; ka[q] += cr * b.x - ci * b.y; } }
        if (j == 0) {
#pragma unroll
            for (int q = 0; q < 16; ++q) if (q == p) ka[q] += I.dsk[g * 16 + p]; }
#pragma unroll
        for (int q = 0; q < 16; ++q) kt[(j * 16 + p) * 16 + q] = ka[q];
    }
    __syncthreads();
    {
        const int rl = tid >> 3, t = 4 * part + (rl >> 4), p = rl & 15;
        bf16* rowp = Bt2 + ((size_t)(g * 512 + t * 16 + p)) * SSM_K2;
        for (int i = 0; i < 10; ++i) { const int k0 = ((tid & 7) + 8 * i) * 8; float v[8];
            if (k0 < 512) { const int s = k0 >> 4, q0 = k0 & 15;
#pragma unroll
                for (int e = 0; e < 8; ++e) v[e] = (s <= t) ? kt[((t - s) * 16 + p) * 16 + q0 + e] : 0.f; }
            else { const bool im = k0 >= 576; const int n0 = k0 - (im ? 576 : 512);
#pragma unroll
                for (int e = 0; e < 8; ++e) { const f32x2 c = ct[(n0 + e) * 16 + p], a = ap[(t + 1) * 64 + n0 + e];
                    v[e] = im ? -(c.x * a.y + c.y * a.x) : (c.x * a.x - c.y * a.y); } }
            v4u o; o.x = pk2(v[0], v[1]); o.y = pk2(v[2], v[3]); o.z = pk2(v[4], v[5]); o.w = pk2(v[6], v[7]);
            *(GAS v4u*)(rowp + k0) = o; }
    }
    {
        for (int i = 0; i < 4; ++i) { const int id = tid + 512 * i, rl = id >> 6, k0 = (id & 63) * 8, s = k0 >> 4, q0 = k0 & 15; float v[8];
            int drow;
            if (rl < 16) { const int r = 16 * part + rl, n = r & 63; const bool im = r >= 64; const f32x2 a = ap[(31 - s) * 64 + n]; drow = r;
#pragma unroll
                for (int e = 0; e < 8; ++e) { const f32x2 b = bb[n * 16 + q0 + e]; v[e] = im ? (a.x * b.y + a.y * b.x) : (a.x * b.x - a.y * b.y); } }
            else { drow = 128 + 16 * part + (rl - 16);
#pragma unroll
                for (int e = 0; e < 8; ++e) v[e] = 0.f; }
            v4u o; o.x = pk2(v[0], v[1]); o.y = pk2(v[2], v[3]); o.z = pk2(v[4], v[5]); o.w = pk2(v[6], v[7]);
            *(GAS v4u*)(Bt1 + ((size_t)(g * 256 + drow)) * 512 + k0) = o; }
    }
    __syncthreads();
}
__device__ __forceinline__ void rows_norm_mod(Frame& F, const float* X, const float* gvec, const float* mod, int sh_off, int sc_off, bf16* out) {
    const int gw = F.vcu * NWAVES + F.wave, NGW = F.G * NWAVES;
    for (int r0 = gw * 8; r0 < TOK; r0 += NGW * 8) {
        const int b = r0 / SEQ;
        f32x4 ga[8], sb[8];
#pragma unroll
        for (int j = 0; j < 8; ++j) { const int col = 4 * F.lane + 256 * j;
            const f32x4 gg = *(const f32x4*)(gvec + col), sc = *(const f32x4*)(mod + (size_t)b * (NMOD * DM) + sc_off + col);
            ga[j] = gg * (1.0f + sc); sb[j] = *(const f32x4*)(mod + (size_t)b * (NMOD * DM) + sh_off + col); }
        for (int r = r0; r < r0 + 8; ++r) {
            const GAS f32x4* xr = (const GAS f32x4*)(X + (size_t)r * DM) + F.lane;
            f32x4 v[8]; float s = 0.f;
#pragma unroll
            for (int j = 0; j < 8; ++j) { v[j] = xr[64 * j]; s += (v[j].x * v[j].x + v[j].y * v[j].y) + (v[j].z * v[j].z + v[j].w * v[j].w); }
            const float rstd = 1.0f / sqrtf(wave_sum(s) * (1.0f / DM) + EPS);
            GAS v2u* o8 = (GAS v2u*)(out + (size_t)r * DM) + F.lane;
#pragma unroll
            for (int j = 0; j < 8; ++j) { const f32x4 y = v[j] * rstd * ga[j] + sb[j]; v2u w; w.x = pk2(y.x, y.y); w.y = pk2(y.z, y.w); o8[64 * j] = w; }
        }
    }
}
__device__ __forceinline__ void rows_final_norm(Frame& F, const float* X, const float* gvec, float* out) {
    const int gw = F.vcu * NWAVES + F.wave, NGW = F.G * NWAVES;
    f32x4 ga[8];
#pragma unroll
    for (int j = 0; j < 8; ++j) ga[j] = *(const f32x4*)(gvec + 4 * F.lane + 256 * j);
    for (int r = gw; r < TOK; r += NGW) {
        const GAS f32x4* xr = (const GAS f32x4*)(X + (size_t)r * DM) + F.lane;
        f32x4 v[8]; float s = 0.f;
#pragma unroll
        for (int j = 0; j < 8; ++j) { v[j] = xr[64 * j]; s += (v[j].x * v[j].x + v[j].y * v[j].y) + (v[j].z * v[j].z + v[j].w * v[j].w); }
        const float rstd = 1.0f / sqrtf(wave_sum(s) * (1.0f / DM) + EPS);
        GAS f32x4* o = (GAS f32x4*)(out + (size_t)r * DM) + F.lane;
#pragma unroll
        for (int j = 0; j < 8; ++j) o[64 * j] = v[j] * rstd * ga[j];
    }
}

namespace att {
constexpr int KS_OFF = 0, VT_OFF = 32768, VT_PITCH = 520, BT_OFF = VT_OFF + 64 * VT_PITCH, LDS_END = BT_OFF + 4 * 196 * 4;
__device__ __forceinline__ int crow(int r, int hi) { return (r & 3) + 8 * (r >> 2) + 4 * hi; }
__device__ __forceinline__ int t5_bucket(int d) {
    if (d < 16) return d;
    int b = 16;
    b += (d >= 19); b += (d >= 21); b += (d >= 24); b += (d >= 27); b += (d >= 31); b += (d >= 35); b += (d >= 40); b += (d >= 46);
    b += (d >= 52); b += (d >= 59); b += (d >= 67); b += (d >= 77); b += (d >= 87); b += (d >= 99); b += (d >= 113);
    return b;
}
__device__ __forceinline__ void attn_unit(Frame& F, int b, int n, int h, bf16* Q, const bf16* Kb, const bf16* Vb, const float* sinks, const float* rel_bias) {
    const int tid = F.tid, lane = F.lane, wid = F.wave, ql = lane & 31, hi = lane >> 5;
    LAS unsigned char* lds = F.lds + RING_OFF;
    const long tok0 = (long)b * SEQ + 128 * (n - 1);
#pragma unroll
    for (int i = 0; i < 4; ++i) { const int id = tid + 512 * i, key = id >> 3, c = id & 7;
        v4u v = {0u, 0u, 0u, 0u}; if (n > 0 || key >= 128) v = *(const v4u*)(Kb + (size_t)(tok0 + key) * KVW + h * 64 + c * 8);
        *(LAS v4u*)(lds + KS_OFF + key * 128 + ((c ^ ((key >> 1) & 7)) << 4)) = v; }
#pragma unroll
    for (int i = 0; i < 4; ++i) { const int id = tid + 512 * i, key = id & 255, c = id >> 8;
        v4u v = {0u, 0u, 0u, 0u}; if (n > 0 || key >= 128) v = *(const v4u*)(Vb + (size_t)(tok0 + key) * KVW + h * 64 + c * 8);
        LAS unsigned short* vt = (LAS unsigned short*)(lds + VT_OFF) + key;
        vt[(8 * c + 0) * 260] = (unsigned short)(v.x & 0xffff); vt[(8 * c + 1) * 260] = (unsigned short)(v.x >> 16);
        vt[(8 * c + 2) * 260] = (unsigned short)(v.y & 0xffff); vt[(8 * c + 3) * 260] = (unsigned short)(v.y >> 16);
        vt[(8 * c + 4) * 260] = (unsigned short)(v.z & 0xffff); vt[(8 * c + 5) * 260] = (unsigned short)(v.z >> 16);
        vt[(8 * c + 6) * 260] = (unsigned short)(v.w & 0xffff); vt[(8 * c + 7) * 260] = (unsigned short)(v.w >> 16); }
    for (int i = tid; i < 4 * 196; i += 512) { const int gg = i / 196, j = i - gg * 196, d = 159 - j;
        ((LAS float*)(lds + BT_OFF))[i] = (d >= 0 && d < 128) ? rel_bias[t5_bucket(d) * 16 + 4 * h + gg] * LOG2E : -1e30f; }
    __syncthreads();
    const int g = wid >> 1, qh = wid & 1, hq = 4 * h + g;
    const float sink2 = sinks[hq] * LOG2E;
    const LAS float* bt = (const LAS float*)(lds + BT_OFF) + g * 196 + (31 - ql + 4 * hi);
    for (int qs = 0; qs < 2; ++qs) {
        const int qi0 = 64 * qh + 32 * qs, kb0 = qi0 >> 5;
        bf16* qrow = Q + ((size_t)b * SEQ + 128 * n + qi0) * AW + hq * 64;
        bf16x8 qf[4];
#pragma unroll
        for (int s = 0; s < 4; ++s) qf[s] = *(const bf16x8*)(qrow + (size_t)ql * AW + 16 * s + 8 * hi);
        f32x16 sc[5];
#pragma unroll
        for (int kb = 0; kb < 5; ++kb) { const int key = 32 * (kb0 + kb) + ql;
            f32x16 a = {0.f, 0.f, 0.f, 0.f, 0.f, 0.f, 0.f, 0.f, 0.f, 0.f, 0.f, 0.f, 0.f, 0.f, 0.f, 0.f};
#pragma unroll
            for (int s = 0; s < 4; ++s) { const int c = 2 * s + hi;
                const bf16x8 kf = *(const LAS bf16x8*)(lds + KS_OFF + key * 128 + ((c ^ ((key >> 1) & 7)) << 4));
                a = __builtin_amdgcn_mfma_f32_32x32x16_bf16(kf, qf[s], a, 0, 0, 0); }
            sc[kb] = a; }
        float mx = -1e30f;
#pragma unroll
        for (int kb = 0; kb < 5; ++kb) { const bool dead = (n == 0) && (kb0 + kb < 4);
#pragma unroll
            for (int r = 0; r < 16; ++r) { const float v = dead ? -1e30f : sc[kb][r] + bt[32 * kb + (r & 3) + 8 * (r >> 2)];
                sc[kb][r] = v; mx = fmaxf(mx, v); } }
        mx = fmaxf(mx, __shfl_xor(mx, 32));
        mx = fmaxf(mx, sink2);
        float ls = 0.f;
#pragma unroll
        for (int kb = 0; kb < 5; ++kb) {
#pragma unroll
            for (int r = 0; r < 16; ++r) { const float p = __builtin_amdgcn_exp2f(sc[kb][r] - mx); sc[kb][r] = p; ls += p; }
            __builtin_amdgcn_sched_barrier(0); }
        ls += __shfl_xor(ls, 32);
        ls += __builtin_amdgcn_exp2f(sink2 - mx);
        const float linv = 1.0f / ls;
        f32x16 o[2];
#pragma unroll
        for (int dh = 0; dh < 2; ++dh) o[dh] = (f32x16){0.f, 0.f, 0.f, 0.f, 0.f, 0.f, 0.f, 0.f, 0.f, 0.f, 0.f, 0.f, 0.f, 0.f, 0.f, 0.f};
#pragma unroll
        for (int kb = 0; kb < 5; ++kb)
#pragma unroll
            for (int s = 0; s < 2; ++s) {
                v4u pw; pw.x = pg8::cvt_pk_bf16(sc[kb][8 * s + 0], sc[kb][8 * s + 1]); pw.y = pg8::cvt_pk_bf16(sc[kb][8 * s + 2], sc[kb][8 * s + 3]);
                pw.z = pg8::cvt_pk_bf16(sc[kb][8 * s + 4], sc[kb][8 * s + 5]); pw.w = pg8::cvt_pk_bf16(sc[kb][8 * s + 6], sc[kb][8 * s + 7]);
                const bf16x8 pf = __builtin_bit_cast(bf16x8, pw);
                const int kbase = 32 * (kb0 + kb) + 16 * s + 4 * hi;
#pragma unroll
                for (int dh = 0; dh < 2; ++dh) { const int d = 32 * dh + ql;
                    const v2u lo = *(const LAS v2u*)(lds + VT_OFF + d * VT_PITCH + kbase * 2), hi8 = *(const LAS v2u*)(lds + VT_OFF + d * VT_PITCH + (kbase + 8) * 2);
                    v4u vw; vw.x = lo.x; vw.y = lo.y; vw.z = hi8.x; vw.w = hi8.y;
                    o[dh] = __builtin_amdgcn_mfma_f32_32x32x16_bf16(pf, __builtin_bit_cast(bf16x8, vw), o[dh], 0, 0, 0); }
                __builtin_amdgcn_sched_barrier(0); }
#pragma unroll
        for (int r = 0; r < 16; ++r) { const int q = crow(r, hi); const float li = __shfl(linv, q);
#pragma unroll
            for (int dh = 0; dh < 2; ++dh) qrow[(size_t)q * AW + 32 * dh + ql] = (bf16)f2bf(o[dh][r] * li); }
    }
    __syncthreads();
}
}

__device__ __forceinline__ void ssm_scan(Frame& F, const float* S, const float* A32, bf16* U, int b, int g) {
    LAS f32x2* ends = (LAS f32x2*)(F.lds + RING_OFF);
    const int n = F.lane, w = F.wave;
    const float ar = A32[(g * 64 + n) * 2], ai = A32[(g * 64 + n) * 2 + 1];
    const float* sp = S + ((size_t)(g * 512 + b * 128 + 16 * w)) * 256 + n;
    float sre[16], sim[16];
#pragma unroll
    for (int c = 0; c < 16; ++c) { sre[c] = sp[c * 256]; sim[c] = sp[c * 256 + 64]; }
    float xr = 0.f, xi = 0.f;
#pragma unroll
    for (int c = 0; c < 16; ++c) { const float tr = ar * xr - ai * xi + sre[c], ti = ar * xi + ai * xr + sim[c]; xr = tr; xi = ti; }
    ends[w * 64 + n] = (f32x2){xr, xi};
    float pr = ar, pi = ai;
#pragma unroll
    for (int k = 0; k < 4; ++k) { const float tr = pr * pr - pi * pi, ti = 2.f * pr * pi; pr = tr; pi = ti; }
    __syncthreads();
    xr = 0.f; xi = 0.f;
    for (int m = 0; m < w; ++m) { const f32x2 e = ends[m * 64 + n]; const float tr = pr * xr - pi * xi + e.x, ti = pr * xi + pi * xr + e.y; xr = tr; xi = ti; }
    bf16* up = U + ((size_t)(g * 512 + b * 128 + 16 * w)) * SSM_K2 + 512 + n;
#pragma unroll
    for (int c = 0; c < 16; ++c) {
        up[c * SSM_K2] = (bf16)f2bf(xr); up[c * SSM_K2 + 64] = (bf16)f2bf(xi);
        const float tr = ar * xr - ai * xi + sre[c], ti = ar * xi + ai * xr + sim[c]; xr = tr; xi = ti; }
    __syncthreads();
}

struct Args { const float* in[26]; float* out; unsigned char* ws; int ph_lo, ph_hi; };
__global__ void __launch_bounds__(NWAVES * 64, 2) mk_fwd(Args args) {
    extern __shared__ __attribute__((aligned(16))) unsigned char lds[];
    Frame F;
    F.lds = (LAS unsigned char*)lds;
    F.MISC = (volatile LAS unsigned*)(F.lds + MISC_OFF);
    F.tid = threadIdx.x; F.lane = F.tid & 63; F.wave = __builtin_amdgcn_readfirstlane(F.tid >> 6);
    F.G = gridDim.x; { const int bx = blockIdx.x; F.vcu = (F.G % 8 == 0) ? (bx % 8) * (F.G / 8) + bx / 8 : bx; }
    unsigned char* ws = args.ws;
    F.ctl = (gu32*)(ws + WS_CTL);
    for (int u = F.tid; u < (LDS_BYTES - LDSCTL_OFF) / 4; u += NWAVES * 64) ((LAS unsigned*)(F.lds + LDSCTL_OFF))[u] = 0u;
    __syncthreads();
    XcdBarrier bar; bar.bar = (unsigned*)(F.ctl + CW_BAR); bar.x = 0; bar.st = nullptr;
    if (N_LAUNCHES == 1) bar = xcd_barrier_post((unsigned*)(F.ctl + CW_BAR), F.MISC + 8);
#define GRID_BAR() do { if (N_LAUNCHES == 1) xcd_barrier(bar); } while (0)
    const int lo = args.ph_lo, hi = args.ph_hi;
#define IN(k) (lo <= (k) && (k) < hi)
#define BOTH(k) (IN(k) && IN((k) + 1))
    const float* x = args.in[0]; const float* cvec = args.in[1]; const float* w_ada = args.in[2]; const float* b_ada = args.in[3];
    const float* norm1_g = args.in[4]; const float* w_in = args.in[5]; const float* b_in = args.in[6]; const float* sinks = args.in[7];
    const float* rel_bias = args.in[8];
    const float* w_glu = args.in[17]; const float* b_glu = args.in[18]; const float* w_attn = args.in[19]; const float* w_ssm = args.in[20];
    const float* w_out = args.in[21]; const float* norm2_g = args.in[22]; const float* w_ff1 = args.in[23]; const float* w_ff2 = args.in[24];
    const float* final_g = args.in[25];
    float* out = args.out;
    float* MOD = (float*)(ws + WS_MOD); float* A32 = (float*)(ws + WS_A32);
    bf16 *W1t = (bf16*)(ws + WS_W1), *W2t = (bf16*)(ws + WS_W2), *H2 = (bf16*)(ws + WS_H2), *Hb = (bf16*)(ws + WS_H), *Qb = (bf16*)(ws + WS_Q);
    bf16 *Kb = (bf16*)(ws + WS_K), *Vb = (bf16*)(ws + WS_V), *Ub = (bf16*)(ws + WS_U), *GAb = (bf16*)(ws + WS_GA), *GSb = (bf16*)(ws + WS_GS);
    bf16 *Zb = (bf16*)(ws + WS_K), *Z2b = (bf16*)(ws + WS_S), *MRG = (bf16*)(ws + WS_H), *HID = (bf16*)(ws + WS_HID);
    float* Sb = (float*)(ws + WS_S);
    bf16 *Wint = (bf16*)(ws + WS_WIN), *Wglut = (bf16*)(ws + WS_WGLU), *Wat = (bf16*)(ws + WS_WA), *Wst = (bf16*)(ws + WS_WS), *Wot = (bf16*)(ws + WS_WO);
    bf16 *Bt1 = (bf16*)(ws + WS_BT1), *Bt2 = (bf16*)(ws + WS_BT2);
    const int bx = blockIdx.x;

    if (IN(0)) {
        if (bx < 192) p0_mod(F, cvec, w_ada, b_ada, MOD, bx);
        {   SsmIn I{args.in[9], args.in[10], args.in[11], args.in[12], args.in[13], args.in[14], args.in[15], args.in[16]};
            for (int it = bx; it < 256; it += F.G) p0_ssm_ops(F, I, Bt1, Bt2, A32, it >> 3, it & 7); }
        {   LAS float* scr = (LAS float*)(F.lds + RING_OFF + F.wave * 16384);
            const int gw = F.vcu * NWAVES + F.wave, NGW = F.G * NWAVES;
            constexpr int I_IN = (DM / 64) * (INW / 32), I_GLU = (SW / 64) * (SW / 32), I_A = (AW / 64) * (DM / 32), I_S = (SW / 64) * (DM / 32), I_O = (DM / 64) * (DM / 32),
                          I_1 = (DM / 64) * (DFF / 32), I_2 = (DFF / 64) * (DM / 32);
            constexpr int NITEMS = I_IN + I_GLU + I_A + I_S + I_O + I_1 + I_2;
            for (int it = gw; it < NITEMS; it += NGW) {
                int r = it;
                if (r < I_IN) { p0_transpose_item(w_in, DM, INW, Wint, scr, r, F.lane); continue; } r -= I_IN;
                if (r < I_GLU) { p0_transpose_item(w_glu, SW, SW, Wglut, scr, r, F.lane); continue; } r -= I_GLU;
                if (r < I_A) { p0_transpose_item(w_attn, AW, DM, Wat, scr, r, F.lane); continue; } r -= I_A;
                if (r < I_S) { p0_transpose_item(w_ssm, SW, DM, Wst, scr, r, F.lane); continue; } r -= I_S;
                if (r < I_O) { p0_transpose_item(w_out, DM, DM, Wot, scr, r, F.lane); continue; } r -= I_O;
                if (r < I_1) { p0_transpose_item(w_ff1, DM, DFF, W1t, scr, r, F.lane); continue; } r -= I_1;
                p0_transpose_item(w_ff2, DFF, DM, W2t, scr, r, F.lane);
            } }
        if (BOTH(0)) GRID_BAR();
    }
    if (IN(1)) { rows_norm_mod(F, x, norm1_g, MOD, 0, DM, Hb); if (BOTH(1)) GRID_BAR(); }
    if (IN(2)) {
        pg8::Gemm g{Hb, Wint, DM, DM, DM}; pg8::StaticOrder S; S.init(TOK, INW, F.G, bx);
        pg8::EpiInProj E{b_in, Qb, Kb, Vb, Ub, GAb, GSb, 0.125f * LOG2E};
        pg8::gemm_phase<pg8::EpiInProj, pg8::StaticOrder, PG8_ALIGN, PG8_SP2>(F.lds + RING_OFF, g, S, E);
        if (BOTH(2)) GRID_BAR();
    }
    if (IN(3)) {
        {   pg8::Gemm g{Ub, Bt1, SSM_K2, 512, 512}; pg8::BatchOrder S{64, 1, 2, F.G, (bx < 64) ? bx : -1};
            pg8::EpiF32 E{Sb, 256};
            pg8::gemm_phase<pg8::EpiF32, pg8::BatchOrder, false, PG8_SP2>(F.lds + RING_OFF, g, S, E); }
        __syncthreads();
        {
            const int na = 512;
            if (bx >= 64) { for (int uidx = bx - 64; uidx < na - 64; uidx += F.G - 64) att::attn_unit(F, uidx >> 7, (uidx >> 2) & 31, uidx & 3, Qb, Kb, Vb, sinks, rel_bias); }
            else { const int uidx = na - 64 + bx; att::attn_unit(F, uidx >> 7, (uidx >> 2) & 31, uidx & 3, Qb, Kb, Vb, sinks, rel_bias); }
        }
        if (BOTH(3)) GRID_BAR();
    }
    if (IN(4)) { for (int it = bx; it < 128; it += F.G) ssm_scan(F, Sb, A32, Ub, it >> 5, it & 31); if (BOTH(4)) GRID_BAR(); }
    if (IN(5)) {
        pg8::Gemm g{Ub, Bt2, SSM_K2, SSM_K2, SSM_K2}; pg8::BatchOrder S{128, 2, 2, F.G, bx};
        pg8::EpiSsmOut E{Zb};
        pg8::gemm_phase<pg8::EpiSsmOut, pg8::BatchOrder, false, PG8_SP2>(F.lds + RING_OFF, g, S, E);
        if (BOTH(5)) GRID_BAR();
    }
    if (IN(6)) {
        pg8::Gemm g{Zb, Wglut, SW, SW, SW}; pg8::StaticOrder S; S.init(TOK, SW, F.G, bx);
        pg8::EpiBf<1> E{Z2b, SW, Zb, b_glu};
        pg8::gemm_phase<pg8::EpiBf<1>, pg8::StaticOrder, false, PG8_SP2>(F.lds + RING_OFF, g, S, E);
        if (BOTH(6)) GRID_BAR();
    }
    if (IN(7)) {
        pg8::Gemm g{Qb, Wat, AW, AW, AW}; pg8::StaticOrder S; S.init(TOK, DM, F.G, bx);
        pg8::EpiBf<2> E{MRG, DM, GAb, nullptr};
        pg8::gemm_phase<pg8::EpiBf<2>, pg8::StaticOrder, PG8_ALIGN, PG8_SP2>(F.lds + RING_OFF, g, S, E);
    }
    if (IN(8)) {
        pg8::Gemm g{Z2b, Wst, SW, SW, SW}; pg8::StaticOrder S; S.init(TOK, DM, F.G, bx);
        pg8::EpiBf<3> E{MRG, DM, GSb, nullptr};
        pg8::gemm_phase<pg8::EpiBf<3>, pg8::StaticOrder, PG8_ALIGN, PG8_SP2>(F.lds + RING_OFF, g, S, E);
        if (BOTH(8)) GRID_BAR();
    }
    if (IN(9)) {
        pg8::Gemm g{MRG, Wot, DM, DM, DM}; pg8::StaticOrder S; S.init(TOK, DM, F.G, bx);
        pg8::EpiResid E{x, out, MOD + 2 * DM, NMOD * DM};
        pg8::gemm_phase<pg8::EpiResid, pg8::StaticOrder, PG8_ALIGN, PG8_SP2>(F.lds + RING_OFF, g, S, E);
        if (BOTH(9)) GRID_BAR();
    }
    if (IN(10)) { rows_norm_mod(F, out, norm2_g, MOD, 3 * DM, 4 * DM, H2); if (BOTH(10)) GRID_BAR(); }
    if (IN(11)) {
        pg8::Gemm g{H2, W1t, DM, DM, DM}; pg8::StaticOrder S; S.init(TOK, DFF, F.G, bx);
        pg8::EpiBf<0> E{HID, DFF, nullptr, nullptr};
        pg8::gemm_phase<pg8::EpiBf<0>, pg8::StaticOrder, PG8_ALIGN, PG8_SP2>(F.lds + RING_OFF, g, S, E);
        if (BOTH(11)) GRID_BAR();
    }
    if (IN(12)) {
        pg8::Gemm g{HID, W2t, DFF, DFF, DFF}; pg8::StaticOrder S; S.init(TOK, DM, F.G, bx);
        pg8::EpiResid E{out, out, MOD + 5 * DM, NMOD * DM};
        pg8::gemm_phase<pg8::EpiResid, pg8::StaticOrder, PG8_ALIGN, PG8_SP2>(F.lds + RING_OFF, g, S, E);
        if (BOTH(12)) GRID_BAR();
    }
    if (IN(13)) { rows_final_norm(F, out, final_g, out); }
#undef IN
#undef BOTH
#undef GRID_BAR
}

extern "C" void kernel_launch(void* const* d_in, const int* in_sizes, int n_in, void* d_out, int out_size, void* d_ws, size_t ws_size, hipStream_t stream) {
    static int grid = 0;
    if (grid == 0) {
        if (n_in != 26 || in_sizes[0] != TOK * DM || out_size != TOK * DM || ws_size < WS_END) { fprintf(stderr, "kernel_launch: unexpected shapes (n_in %d, in0 %d, out %d, ws %zu)\n", n_in, n_in > 0 ? in_sizes[0] : -1, out_size, ws_size); grid = -1; return; }
        int dev = 0, cus = 0, per_cu = 0;
        if (hipGetDevice(&dev) != hipSuccess || hipDeviceGetAttribute(&cus, hipDeviceAttributeMultiprocessorCount, dev) != hipSuccess) { grid = -1; return; }
        if (hipFuncSetAttribute((const void*)mk_fwd, hipFuncAttributeMaxDynamicSharedMemorySize, LDS_BYTES) != hipSuccess) { fprintf(stderr, "kernel_launch: hipFuncSetAttribute failed\n"); grid = -1; return; }
        if (hipOccupancyMaxActiveBlocksPerMultiprocessor(&per_cu, (const void*)mk_fwd, NWAVES * 64, LDS_BYTES) != hipSuccess || per_cu < 1)
            fprintf(stderr, "kernel_launch: note: occupancy query reports %d workgroups per CU\n", per_cu);
        (void)hipGetLastError();
        grid = cus;
    }
    if (grid < 0) return;
    if (hipMemsetAsync((char*)d_ws + WS_CTL, 0, CTL_ZERO_BYTES, stream) != hipSuccess) return;
    Args a{};
    for (int i = 0; i < 26; ++i) a.in[i] = (const float*)d_in[i];
    a.out = (float*)d_out; a.ws = (unsigned char*)d_ws;
    for (int li = 0; li < N_LAUNCHES; ++li) {
        a.ph_lo = (N_LAUNCHES == 1) ? 0 : li; a.ph_hi = (N_LAUNCHES == 1) ? N_PHASES : li + 1;
        hipLaunchKernelGGL(mk_fwd, dim3(grid), dim3(NWAVES * 64), LDS_BYTES, stream, a);
    }
}
```
